# Optimizing an MI355X kernel written in HIP

```python
import jax, jax.numpy as jnp
from jax import lax
import numpy as np

D_MODEL = 2048
BATCH = 8
SEQ = 2048
DEPTH = 1

HEAD_DIM = 64
MIX_WIDTH = D_MODEL
N_HEADS_A = (MIX_WIDTH // 2) // HEAD_DIM
N_HEADS_B = (MIX_WIDTH // 2) // HEAD_DIM
WIDTH_A = N_HEADS_A * HEAD_DIM
WIDTH_B = N_HEADS_B * HEAD_DIM
IN_WIDTH = 4 * WIDTH_A + 4 * WIDTH_B
DILATED_CONFIGS = ((128, 1), (512, 4), (2048, 16))
NUM_BUCKETS = 32
T5_MAX_DISTANCE = 1024
GRID_W = 64
NA_ROWS = 8
NA_COLS = 16
NA_COL_BLOCKS = GRID_W // NA_COLS
NA_KEY_COLS = 2 * NA_COLS
DEEPNORM_ALPHA = (2.0 * DEPTH) ** 0.25
DEEPNORM_BETA = (8.0 * DEPTH) ** -0.25
LN_EPS = 1e-5
NEG_INF = -1e30

kernel_name = "hybrid_dilated_neighbourhood_encoder"


def _t5_buckets(rel):
    half = NUM_BUCKETS // 2
    max_exact = half // 2
    n = np.abs(rel)
    large = max_exact + (np.log(np.maximum(n, 1) / max_exact)
                         / np.log(T5_MAX_DISTANCE / max_exact)
                         * (half - max_exact)).astype(np.int64)
    large = np.minimum(large, half - 1)
    return ((rel > 0).astype(np.int64) * half + np.where(n < max_exact, n, large)).astype(np.int32)


def _layer_norm(x, g, b):
    xf = x.astype(jnp.float32)
    mu = xf.mean(-1, keepdims=True)
    var = jnp.square(xf - mu).mean(-1, keepdims=True)
    return ((xf - mu) * lax.rsqrt(var + LN_EPS) * g.astype(jnp.float32)
            + b.astype(jnp.float32)).astype(x.dtype)


def _dilated_branch(q, k, v, t5_table, window, dilation):
    B, H, S, hd = q.shape
    blk = window // (2 * dilation)
    L = S // dilation
    nb = -(-L // blk)
    Lp = nb * blk
    scale = HEAD_DIM ** -0.5

    def strided(a):
        return a.reshape(B, H, L, dilation, hd).transpose(0, 1, 3, 2, 4)

    qs = jnp.pad(strided(q), ((0, 0), (0, 0), (0, 0), (0, Lp - L), (0, 0)))
    qs = qs.reshape(B, H, dilation, nb, blk, hd)

    def key_blocks(a):
        a = jnp.pad(strided(a), ((0, 0), (0, 0), (0, 0), (blk, Lp - L + blk), (0, 0)))
        a = a.reshape(B, H, dilation, nb + 2, blk, hd)
        return jnp.concatenate([a[:, :, :, :nb], a[:, :, :, 1:nb + 1], a[:, :, :, 2:]], axis=4)

    ks, vs = key_blocks(k), key_blocks(v)
    rel = np.arange(3 * blk)[None, :] - blk - np.arange(blk)[:, None]
    band = np.abs(rel) <= blk
    key_abs = (np.arange(nb)[:, None] - 1) * blk + np.arange(3 * blk)[None, :]
    valid = (key_abs >= 0) & (key_abs < L)
    mask = band[None] & valid[:, None, :]
    bias = jnp.take(t5_table, _t5_buckets(rel * dilation), axis=0)
    bias = jnp.moveaxis(bias.astype(jnp.float32), -1, 0)

    s = jnp.einsum('bhrnqd,bhrnkd->bhrnqk', qs, ks).astype(jnp.float32) * scale
    s = jnp.where(mask, s + bias[None, :, None, None], NEG_INF)
    m = s.max(-1, keepdims=True)
    p = jnp.exp(s - m)
    den = p.sum(-1, keepdims=True)
    o = jnp.einsum('bhrnqk,bhrnkd->bhrnqd', p, vs.astype(jnp.float32)) / den
    lse = (m + jnp.log(den))[..., 0]
    o = o.reshape(B, H, dilation, Lp, hd)[:, :, :, :L].transpose(0, 1, 3, 2, 4).reshape(B, H, S, hd)
    lse = lse.reshape(B, H, dilation, Lp)[..., :L].transpose(0, 1, 3, 2).reshape(B, H, S)
    return o, lse


def _dilated_attention(q, k, v, t5_table):
    outs, lses = [], []
    for window, dilation in DILATED_CONFIGS:
        o, lse = _dilated_branch(q, k, v, t5_table, window, dilation)
        outs.append(o)
        lses.append(lse)
    wts = jax.nn.softmax(jnp.stack(lses, 0), axis=0)
    return jnp.einsum('cbhs,cbhsd->bhsd', wts, jnp.stack(outs, 0))


def _neighbourhood_attention(q, k, v, rpb):
    B, H, S, hd = q.shape
    rows = S // GRID_W
    kr = min(NA_ROWS, rows)
    scale = HEAD_DIM ** -0.5
    row_start = np.clip(np.arange(rows) - kr // 2, 0, rows - kr)
    row_idx = row_start[:, None] + np.arange(kr)
    qcol = np.arange(GRID_W).reshape(NA_COL_BLOCKS, NA_COLS)
    blk_start = np.clip(qcol[:, 0] - NA_COLS // 2, 0, GRID_W - NA_KEY_COLS)
    col_idx = blk_start[:, None] + np.arange(NA_KEY_COLS)
    q_start = np.clip(qcol - NA_COLS // 2, 0, GRID_W - NA_COLS)
    kcol = col_idx[:, None, :]
    col_mask = (kcol >= q_start[:, :, None]) & (kcol < q_start[:, :, None] + NA_COLS)
    dcol = np.clip(kcol - qcol[:, :, None], -(NA_COLS - 1), NA_COLS - 1)
    drow = row_idx - np.arange(rows)[:, None]
    ri = (drow + NA_ROWS - 1)[None, :, None, :, None]
    ci = (dcol + NA_COLS - 1)[:, None, :, None, :]
    bias = rpb.astype(jnp.float32)[:, ri, ci]
    bias = jnp.where(col_mask[:, None, :, None, :], bias, NEG_INF)
    bias = bias.transpose(1, 0, 2, 3, 4, 5).reshape(NA_COL_BLOCKS, H, rows, NA_COLS, kr * NA_KEY_COLS)

    qb = q.reshape(B, H, rows, NA_COL_BLOCKS, NA_COLS, hd).transpose(3, 0, 1, 2, 4, 5)
    kg = k.reshape(B, H, rows, GRID_W, hd)
    vg = v.reshape(B, H, rows, GRID_W, hd)

    def row_block(args):
        q_blk, cidx, bias_blk = args
        k_blk = jnp.take(kg, cidx, axis=3)[:, :, row_idx].reshape(B, H, rows, kr * NA_KEY_COLS, hd)
        v_blk = jnp.take(vg, cidx, axis=3)[:, :, row_idx].reshape(B, H, rows, kr * NA_KEY_COLS, hd)
        s = jnp.einsum('bhrqd,bhrkd->bhrqk', q_blk, k_blk).astype(jnp.float32) * scale + bias_blk[None]
        p = jax.nn.softmax(s, axis=-1)
        return jnp.einsum('bhrqk,bhrkd->bhrqd', p, v_blk.astype(jnp.float32))

    o = lax.map(row_block, (qb, jnp.asarray(col_idx, jnp.int32), bias))
    return o.transpose(1, 2, 3, 0, 4, 5).reshape(B, H, S, hd)


def setup_inputs(seed: int = 0) -> dict:
    key = jax.random.key(seed)
    ks = jax.random.split(key, 7)
    x = jax.random.normal(ks[0], (BATCH, SEQ, D_MODEL), jnp.float32)
    col_scale = np.ones((IN_WIDTH,), np.float32)
    col_scale[2 * WIDTH_A:3 * WIDTH_A] = DEEPNORM_BETA
    col_scale[4 * WIDTH_A + 2 * WIDTH_B:4 * WIDTH_A + 3 * WIDTH_B] = DEEPNORM_BETA
    w_in = (jax.random.normal(ks[1], (DEPTH, D_MODEL, IN_WIDTH), jnp.float32)
            * D_MODEL ** -0.5 * jnp.asarray(col_scale))
    w_out = jax.random.normal(ks[2], (DEPTH, MIX_WIDTH, D_MODEL), jnp.float32) * (MIX_WIDTH ** -0.5 * DEEPNORM_BETA)
    t5_bias = jax.random.normal(ks[3], (NUM_BUCKETS, N_HEADS_A), jnp.float32) * 0.5
    na_rpb = jax.random.normal(ks[4], (DEPTH, N_HEADS_B, 2 * NA_ROWS - 1, 2 * NA_COLS - 1), jnp.float32) * 0.5
    ln_gain = 1.0 + 0.05 * jax.random.normal(ks[5], (DEPTH, D_MODEL), jnp.float32)
    ln_bias = 0.02 * jax.random.normal(ks[6], (DEPTH, D_MODEL), jnp.float32)
    return {"x": x, "w_in": w_in, "w_out": w_out, "t5_bias": t5_bias,
            "na_rpb": na_rpb, "ln_gain": ln_gain, "ln_bias": ln_bias}


def reference(x, w_in, w_out, t5_bias, na_rpb, ln_gain, ln_bias):
    B, S, _ = x.shape
    splits = np.cumsum([WIDTH_A] * 4 + [WIDTH_B] * 3)

    def heads(a, n):
        return a.reshape(B, S, n, HEAD_DIM).transpose(0, 2, 1, 3)

    def merge(o):
        return o.transpose(0, 2, 1, 3).reshape(B, S, -1)

    for layer in range(DEPTH):
        h = jnp.einsum('bsd,de->bse', x, w_in[layer])
        qa, ka, va, ga, qb, kb, vb, gb = jnp.split(h, splits, axis=-1)
        ya = _dilated_attention(heads(qa, N_HEADS_A), heads(ka, N_HEADS_A), heads(va, N_HEADS_A), t5_bias)
        yb = _neighbourhood_attention(heads(qb, N_HEADS_B), heads(kb, N_HEADS_B), heads(vb, N_HEADS_B), na_rpb[layer])
        ya = merge(ya) * jax.nn.silu(ga.astype(jnp.float32))
        yb = merge(yb) * jax.nn.silu(gb.astype(jnp.float32))
        y = jnp.concatenate([ya, yb], axis=-1).astype(x.dtype)
        out = jnp.einsum('bse,ed->bsd', y, w_out[layer])
        x = _layer_norm(DEEPNORM_ALPHA * x + out, ln_gain[layer], ln_bias[layer])
    return x
```

```cpp
#include <hip/hip_runtime.h>
#include <hip/hip_cooperative_groups.h>
#include <cstdio>
#include <cstdint>
namespace pg8 {
#define PG8_LAS __attribute__((address_space(3)))
typedef unsigned short bf16_t;
typedef short bf16x8 __attribute__((ext_vector_type(8)));
typedef float f32x4 __attribute__((ext_vector_type(4)));
typedef unsigned u32x4 __attribute__((ext_vector_type(4)));
constexpr int BM = 256, BK = 64, HALF = 128, HTB = HALF * BK * 2  , STAGE_BYTES = 8 * HTB, NXCD = 8, WGM = 8;

__host__ __device__ __forceinline__ int lds_byte(int r, int c) { const int st = (r >> 4) * 2 + (c >> 5), rr = r & 15, cc = c & 31, ob = rr * 64 + cc * 2; return st * 1024 + (ob ^ (((ob >> 9) & 1) << 5)); }
__host__ __device__ __forceinline__ void stage_rc(int b, int& R, int& C) { const int st = b / 1024, sb = b % 1024, swz = sb ^ (((sb >> 9) & 1) << 5); R = (st >> 1) * 16 + swz / 64; C = (st & 1) * 32 + (swz % 64) / 2; }
__host__ __device__ __forceinline__ int perm32(int rho) { const int n = rho >> 4, i = rho & 15; return 8 * (i >> 2) + 4 * n + (i & 3); }

struct Unit { int pm, pn; };
struct Gemm { const bf16_t* A; const bf16_t* Bt; int M, N, K; };

struct StaticOrder {
    int nM, nN, nwg, G, c;
    __host__ __device__ void init(int M, int N, int G_, int c_) { nM = M / BM; nN = N / BM; nwg = nM * nN; G = G_; c = c_; }
    __host__ __device__ bool next(int i, Unit& u) const {
        const long L = (long)i * G + c; if (L >= nwg) return false;
        int wgid = (int)L; { const int q = nwg / NXCD, r = nwg % NXCD, xcd = wgid % NXCD, off = wgid / NXCD; wgid = (xcd < r ? xcd * (q + 1) : r * (q + 1) + (xcd - r) * q) + off; }
        const int nig = WGM * nN, gid = wgid / nig, fm = gid * WGM, gsz = (nM - fm) < WGM ? (nM - fm) : WGM;
        u.pm = fm + ((wgid % nig) % gsz); u.pn = (wgid % nig) / gsz; return true;
    }
    __device__ __forceinline__ void a_ready(const Unit&) const {}
    __device__ __forceinline__ void done(const Unit&) const {}
};

__device__ __forceinline__ unsigned cvt_pk_bf16(float lo, float hi) { unsigned r; asm volatile("v_cvt_pk_bf16_f32 %0, %1, %2" : "=v"(r) : "v"(lo), "v"(hi)); return r; }
typedef float f32x2 __attribute__((ext_vector_type(2)));
__device__ __forceinline__ f32x2 gelu_pk(f32x2 v) {
    const f32x2 av = __builtin_elementwise_abs(v), d = av * 0.2316418882f + 1.0f;
    f32x2 t; t.x = __builtin_amdgcn_rcpf(d.x); t.y = __builtin_amdgcn_rcpf(d.y);
    f32x2 q = t * 0.5307027145f + (-0.7265760135f); q = q * t + 0.7107068705f; q = q * t + (-0.142248368f); q = q * t + 0.127414796f; q = q * t;
    const f32x2 s = (v * v) * (-0.72134752044f);
    f32x2 e; e.x = __builtin_amdgcn_exp2f(s.x); e.y = __builtin_amdgcn_exp2f(s.y);
    const f32x2 m = v * (q * e), r = v - m;
    f32x2 o; o.x = v.x < 0.f ? m.x : r.x; o.y = v.y < 0.f ? m.y : r.y; return o;
}

template <int ACT  > struct EpiBf16 {
    static constexpr bool PERM = true, AFTER_DRAIN = false; static_assert(ACT == 0 || ACT == 1, "EpiBf16: ACT is 0 (none) or 1 (gelu_pk)");
    bf16_t* O; int ldc; const float* bias; int split_cols; size_t split_stride; float scale0;
    __device__ __forceinline__ void operator()(const f32x4 (&acc)[2][2][4][2], const Unit& u, int wr, int wc, int fr, int fq) const {
        const int row0 = u.pm * BM + wr * 64 + fr; int colt = u.pn * BM; bf16_t* base = O;
        float sc = 1.f; if (split_cols) { const int t = colt / split_cols; base += (size_t)t * split_stride; colt -= t * split_cols; if (t == 0) sc = scale0; }
        const int col0 = colt + wc * 32 + 8 * fq, bcol0 = u.pn * BM + wc * 32 + 8 * fq;
        f32x4 bv[2][2];
#pragma unroll
        for (int bj = 0; bj < 2; ++bj)
#pragma unroll
            for (int n = 0; n < 2; ++n) bv[bj][n] = bias ? *(const f32x4*)(bias + bcol0 + bj * HALF + 4 * n) : (f32x4){0.f, 0.f, 0.f, 0.f};
#pragma unroll
        for (int ai = 0; ai < 2; ++ai)
#pragma unroll
            for (int m = 0; m < 4; ++m) { bf16_t* rowp = base + (size_t)(row0 + ai * HALF + m * 16) * ldc + col0;
#pragma unroll
                for (int bj = 0; bj < 2; ++bj) { f32x4 v0 = acc[ai][bj][m][0] + bv[bj][0], v1 = acc[ai][bj][m][1] + bv[bj][1];
                    if (ACT == 1) { f32x2 a = gelu_pk((f32x2){v0[0], v0[1]}), b = gelu_pk((f32x2){v0[2], v0[3]}), c = gelu_pk((f32x2){v1[0], v1[1]}), d = gelu_pk((f32x2){v1[2], v1[3]});
                        v0 = (f32x4){a.x, a.y, b.x, b.y}; v1 = (f32x4){c.x, c.y, d.x, d.y}; }
                    v0 = v0 * sc; v1 = v1 * sc; u32x4 w; w.x = cvt_pk_bf16(v0[0], v0[1]); w.y = cvt_pk_bf16(v0[2], v0[3]); w.z = cvt_pk_bf16(v1[0], v1[1]); w.w = cvt_pk_bf16(v1[2], v1[3]);
                    *(u32x4*)(rowp + bj * HALF) = w; } }
    }
};
struct EpiResF32 {
    static constexpr bool PERM = false, AFTER_DRAIN = false;
    float* C; int ldc; const float* X; float alpha;
    __device__ __forceinline__ void operator()(const f32x4 (&acc)[2][2][4][2], const Unit& u, int wr, int wc, int fr, int fq) const {
        const int row0 = u.pm * BM + wr * 64 + fr, col0 = u.pn * BM + wc * 32 + 4 * fq;
#pragma unroll
        for (int ai = 0; ai < 2; ++ai)
#pragma unroll
            for (int m = 0; m < 4; ++m) { const size_t off = (size_t)(row0 + ai * HALF + m * 16) * ldc + col0;
#pragma unroll
                for (int bj = 0; bj < 2; ++bj)
#pragma unroll
                    for (int n = 0; n < 2; ++n) { const f32x4 xv = *(const f32x4*)(X + off + bj * HALF + n * 16); *(f32x4*)(C + off + bj * HALF + n * 16) = acc[ai][bj][m][n] + xv * alpha; } }
    }
};
template <class Epi, class Sched, bool ALIGN_EPI = false, bool SP2 = false>
__device__ __forceinline__ void gemm_phase(PG8_LAS unsigned char* lds, const Gemm g, const Sched& S, const Epi& E) {
    const int tid = threadIdx.x, wid = __builtin_amdgcn_readfirstlane(tid >> 6), lane = tid & 63, wr = wid >> 2, wc = wid & 3, fr = lane & 15, fq = lane >> 4;
    const int K = g.K, nt = K / BK;
    unsigned voffA[2], voffB[2];
#pragma unroll
    for (int i = 0; i < 2; ++i) { int R, C; stage_rc(tid * 16 + i * 8192, R, C); const int Rb = Epi::PERM ? ((R & ~31) + perm32(R & 31)) : R;
        voffA[i] = (unsigned)(R * K + C) * 2u; voffB[i] = (unsigned)(Rb * K + C) * 2u; }
    const size_t kstep = (size_t)(BK * 2);
    const size_t hstep = (size_t)HALF * K * 2;
    const size_t tstep = 2 * hstep;
    const unsigned ldsw = (unsigned)wid * 1024u;
    const int aoff = lds_byte(wr * 64 + fr, fq * 8), boff = lds_byte(wc * 32 + fr, fq * 8);
#define PG8_SA(b, h) (((b) * 2 + (h)) * HTB)
#define PG8_SB(b, h) ((4 + (b) * 2 + (h)) * HTB)
#define PG8_STAGE(bufoff, gbase, voff) do { _Pragma("unroll") for (int _i = 0; _i < 2; ++_i) \
        __builtin_amdgcn_global_load_lds((const unsigned*)((const char*)(gbase) + (voff)[_i]), (PG8_LAS unsigned*)(lds + (bufoff) + ldsw + _i * 8192), 16, 0, 0); } while (0)
#define PG8_LDA(dst, b, h) do { _Pragma("unroll") for (int m = 0; m < 4; ++m) _Pragma("unroll") for (int k = 0; k < 2; ++k) dst[m][k] = *(const PG8_LAS bf16x8*)(lds + PG8_SA(b, h) + aoff + m * 2048 + k * 1024); } while (0)
#define PG8_LDB(dst, b, h) do { _Pragma("unroll") for (int n = 0; n < 2; ++n) _Pragma("unroll") for (int k = 0; k < 2; ++k) dst[n][k] = *(const PG8_LAS bf16x8*)(lds + PG8_SB(b, h) + boff + n * 2048 + k * 1024); } while (0)
#define PG8_MMA(ai, bj, At, Bt) do { __builtin_amdgcn_s_setprio(1); _Pragma("unroll") for (int m = 0; m < 4; ++m) _Pragma("unroll") for (int n = 0; n < 2; ++n) _Pragma("unroll") for (int k = 0; k < 2; ++k) \
        acc[ai][bj][m][n] = __builtin_amdgcn_mfma_f32_16x16x32_bf16(Bt[n][k], At[m][k], acc[ai][bj][m][n], 0, 0, 0); __builtin_amdgcn_s_setprio(0); } while (0)
#define PG8_WAIT_V(n) asm volatile("s_waitcnt vmcnt(" #n ")" ::: "memory")
#define PG8_WAIT_L(n) asm volatile("s_waitcnt lgkmcnt(" #n ")" ::: "memory")
#define PG8_BAR __builtin_amdgcn_s_barrier()
#define PG8_SCHED __builtin_amdgcn_sched_barrier(0)
    Unit cur, nxt; int ui = 0;
    if (!S.next(0, cur)) return;
    f32x4 acc[2][2][4][2];
#pragma unroll
    for (int a = 0; a < 2; ++a)
#pragma unroll
        for (int b = 0; b < 2; ++b)
#pragma unroll
            for (int m = 0; m < 4; ++m)
#pragma unroll
                for (int n = 0; n < 2; ++n) acc[a][b][m][n] = (f32x4){0.f, 0.f, 0.f, 0.f};
    bf16x8 At[4][2], B0[2][2], B1[2][2];
    const char* cA = (const char*)g.A + (size_t)cur.pm * tstep; const char* cB = (const char*)g.Bt + (size_t)cur.pn * tstep;
    S.a_ready(cur);
    if constexpr (SP2) {
        PG8_STAGE(PG8_SB(0, 0), cB, voffB); PG8_STAGE(PG8_SB(0, 1), cB + hstep, voffB); PG8_STAGE(PG8_SA(0, 0), cA, voffA); PG8_STAGE(PG8_SA(0, 1), cA + hstep, voffA);
        if (wr == 1) PG8_BAR;
        PG8_WAIT_V(2); PG8_BAR;
        PG8_STAGE(PG8_SB(1, 0), cB + kstep, voffB); PG8_STAGE(PG8_SA(1, 0), cA + kstep, voffA); PG8_STAGE(PG8_SB(1, 1), cB + hstep + kstep, voffB);
        PG8_WAIT_V(6); PG8_BAR;
    } else {
        PG8_STAGE(PG8_SB(0, 0), cB, voffB); PG8_STAGE(PG8_SA(0, 0), cA, voffA); PG8_STAGE(PG8_SB(0, 1), cB + hstep, voffB); PG8_STAGE(PG8_SA(0, 1), cA + hstep, voffA);
        if (wr == 1) PG8_BAR;
        PG8_WAIT_V(4); PG8_BAR;
        PG8_STAGE(PG8_SB(1, 0), cB + kstep, voffB); PG8_STAGE(PG8_SA(1, 0), cA + kstep, voffA); PG8_STAGE(PG8_SB(1, 1), cB + hstep + kstep, voffB);
        PG8_WAIT_V(6); PG8_BAR;
    }
    for (;;) {
        const bool has_next = S.next(ui + 1, nxt);
        const char* nA = has_next ? (const char*)g.A + (size_t)nxt.pm * tstep : cA; const char* nB = has_next ? (const char*)g.Bt + (size_t)nxt.pn * tstep : cB;
        for (int t = 0; t < nt; t += 2) {
            const bool last = (t == nt - 2);
            const char* a1 = cA + (size_t)(t + 1) * kstep;
            const char* a2 = last ? nA : cA + (size_t)(t + 2) * kstep; const char* b2 = last ? nB : cB + (size_t)(t + 2) * kstep;
            const char* a3 = a2 + kstep; const char* b3 = b2 + kstep;
            if (last && has_next) S.a_ready(nxt);
            if constexpr (SP2) {
            PG8_LDB(B0, 0, 0); PG8_LDB(B1, 0, 1); PG8_SCHED; PG8_LDA(At, 0, 0); PG8_STAGE(PG8_SA(1, 1), a1 + hstep, voffA);
            PG8_WAIT_V(8); PG8_WAIT_L(0); PG8_BAR; PG8_MMA(0, 0, At, B0); PG8_MMA(0, 1, At, B1); PG8_BAR; PG8_SCHED;
            PG8_LDA(At, 0, 1); PG8_STAGE(PG8_SB(0, 0), b2, voffB); PG8_STAGE(PG8_SB(0, 1), b2 + hstep, voffB); PG8_STAGE(PG8_SA(0, 0), a2, voffA);
            PG8_WAIT_V(8); PG8_WAIT_L(0); PG8_BAR; PG8_MMA(1, 0, At, B0); PG8_MMA(1, 1, At, B1); PG8_BAR; PG8_SCHED;
            PG8_LDB(B0, 1, 0); PG8_LDB(B1, 1, 1); PG8_SCHED; PG8_LDA(At, 1, 0); PG8_STAGE(PG8_SA(0, 1), a2 + hstep, voffA);
            PG8_WAIT_V(8); PG8_WAIT_L(0); PG8_BAR; PG8_MMA(0, 0, At, B0); PG8_MMA(0, 1, At, B1); PG8_BAR; PG8_SCHED;
            PG8_LDA(At, 1, 1); PG8_STAGE(PG8_SB(1, 0), b3, voffB); PG8_STAGE(PG8_SB(1, 1), b3 + hstep, voffB); PG8_STAGE(PG8_SA(1, 0), a3, voffA);
            PG8_WAIT_V(8); PG8_WAIT_L(0); PG8_BAR; PG8_MMA(1, 0, At, B0); PG8_MMA(1, 1, At, B1); PG8_BAR; PG8_SCHED;
            } else {
            PG8_LDB(B0, 0, 0); PG8_SCHED; PG8_LDA(At, 0, 0); PG8_STAGE(PG8_SA(1, 1), a1 + hstep, voffA);
            PG8_WAIT_L(8); PG8_BAR; PG8_WAIT_L(0); PG8_MMA(0, 0, At, B0); PG8_BAR; PG8_SCHED;
            PG8_LDB(B1, 0, 1); PG8_STAGE(PG8_SB(0, 0), b2, voffB);
            PG8_BAR; PG8_WAIT_L(0); PG8_MMA(0, 1, At, B1); PG8_BAR;
            PG8_LDA(At, 0, 1); PG8_STAGE(PG8_SA(0, 0), a2, voffA);
            PG8_BAR; PG8_WAIT_L(0); PG8_MMA(1, 0, At, B0); PG8_BAR; PG8_SCHED;
            PG8_STAGE(PG8_SB(0, 1), b2 + hstep, voffB);
            PG8_WAIT_V(6); PG8_BAR; PG8_MMA(1, 1, At, B1); PG8_BAR;
            PG8_LDB(B0, 1, 0); PG8_SCHED; PG8_LDA(At, 1, 0); PG8_STAGE(PG8_SA(0, 1), a2 + hstep, voffA);
            PG8_WAIT_L(8); PG8_BAR; PG8_WAIT_L(0); PG8_MMA(0, 0, At, B0); PG8_BAR; PG8_SCHED;
            PG8_LDB(B1, 1, 1); PG8_STAGE(PG8_SB(1, 0), b3, voffB);
            PG8_BAR; PG8_WAIT_L(0); PG8_MMA(0, 1, At, B1); PG8_BAR;
            PG8_LDA(At, 1, 1); PG8_STAGE(PG8_SA(1, 0), a3, voffA);
            PG8_BAR; PG8_WAIT_L(0); PG8_MMA(1, 0, At, B0); PG8_BAR; PG8_SCHED;
            PG8_STAGE(PG8_SB(1, 1), b3 + hstep, voffB);
            PG8_WAIT_V(6); PG8_BAR; PG8_MMA(1, 1, At, B1); PG8_BAR;
            }
        }
        if constexpr (ALIGN_EPI) { if (wr == 0) PG8_BAR; }
        if constexpr (!Epi::AFTER_DRAIN) { E(acc, cur, wr, wc, fr, fq); S.done(cur); }
        if (!has_next) break;
#pragma unroll
        for (int a = 0; a < 2; ++a)
#pragma unroll
            for (int b = 0; b < 2; ++b)
#pragma unroll
                for (int m = 0; m < 4; ++m)
#pragma unroll
                    for (int n = 0; n < 2; ++n) acc[a][b][m][n] = (f32x4){0.f, 0.f, 0.f, 0.f};
        cur = nxt; cA = nA; cB = nB; ++ui;
        if constexpr (ALIGN_EPI) { if (wr == 1) PG8_BAR; }
    }
    PG8_WAIT_V(0);
    if constexpr (!ALIGN_EPI) { if (wr == 0) PG8_BAR; }
    PG8_BAR;
    if constexpr (Epi::AFTER_DRAIN) { E.fused(acc, cur, wr, wc, fr, fq, lds, wid, lane); S.done(cur); }
#undef PG8_SA
#undef PG8_SB
#undef PG8_STAGE
#undef PG8_LDA
#undef PG8_LDB
#undef PG8_MMA
#undef PG8_WAIT_V
#undef PG8_WAIT_L
#undef PG8_BAR
#undef PG8_SCHED
}
}
namespace att {
#define ATT_LAS __attribute__((address_space(3)))
typedef unsigned short bf16_t;
typedef short bf16x8 __attribute__((ext_vector_type(8)));
typedef short s16x4 __attribute__((ext_vector_type(4)));
typedef short v4i16_t __attribute__((ext_vector_type(4)));
typedef float f32x16 __attribute__((ext_vector_type(16)));
typedef float f32x4 __attribute__((ext_vector_type(4)));
typedef unsigned u32x4 __attribute__((ext_vector_type(4)));
typedef float f32x2_t __attribute__((ext_vector_type(2)));
typedef __bf16 bf16x2_t __attribute__((ext_vector_type(2)));
constexpr float NEGV = -1.0e30f, LOG2E = 1.4426950408889634f;
constexpr int SEQ = 2048, NH = 16, HD = 64, PITCH = NH * HD;
constexpr int WAVE_STRIDE = 8192 + 512;
constexpr int TABD_OFF = 8 * WAVE_STRIDE;
constexpr int TABN_OFF = TABD_OFF + 3 * 1024;
constexpr int TABN_SET = 640 * 4;
constexpr int LDS_END = TABN_OFF + 15 * TABN_SET;

__device__ __forceinline__ int crow(int r, int hi) { return (r & 3) + 8 * (r >> 2) + 4 * hi; }
__device__ __forceinline__ unsigned cvtpk(float lo, float hi) { f32x2_t v = {lo, hi}; bf16x2_t b = __builtin_convertvector(v, bf16x2_t); return __builtin_bit_cast(unsigned, b); }
__device__ __forceinline__ s16x4 vtr(const ATT_LAS char* p) { return __builtin_bit_cast(s16x4, __builtin_amdgcn_ds_read_tr16_b64_v4i16((ATT_LAS v4i16_t*)p)); }
__device__ __forceinline__ float bflo(unsigned u) { return __uint_as_float(u << 16); }
__device__ __forceinline__ float bfhi(unsigned u) { return __uint_as_float(u & 0xffff0000u); }
__device__ __forceinline__ float silu(float g) { return g * __builtin_amdgcn_rcpf(1.0f + __builtin_amdgcn_exp2f(-g * LOG2E)); }

__device__ __forceinline__ int t5_bucket(int rel) {
    const int n = rel < 0 ? -rel : rel; int v;
    if (n < 8) v = n; else { v = 8 + (n >= 15) + (n >= 27) + (n >= 50) + (n >= 91) + (n >= 166) + (n >= 305) + (n >= 559); v = v > 15 ? 15 : v; }
    return v + (rel > 0 ? 16 : 0);
}

__device__ __forceinline__ void build_tables(ATT_LAS char* lds, const float* t5  , const float* rpb  , int hA, int hB, int tid) {
    ATT_LAS float* td = (ATT_LAS float*)(lds + TABD_OFF);
    for (int idx = tid; idx < 3 * 256; idx += 512) {
        const int br = idx >> 8, i = idx & 255, dl = i - 127, dil = br == 0 ? 1 : (br == 1 ? 4 : 16);
        float v = NEGV;
        if (dl >= -64 && dl <= 64) v = t5[t5_bucket(dl * dil) * 16 + hA] * LOG2E;
        td[idx] = v;
    }
    ATT_LAS float* tn = (ATT_LAS float*)(lds + TABN_OFF);
    for (int idx = tid; idx < 15 * 640; idx += 512) {
        const int dd = idx / 640, e = idx % 640; const float* R = rpb + (hB * 15 + dd) * 31;
        float v = NEGV;
        if (e < 128) { const int dl = e - 63; if (dl >= -8 && dl <= 7) v = R[dl + 15] * LOG2E; }
        else if (e < 384) { const int c = (e - 128) >> 5, kc = (e - 128) & 31; if (kc <= 15) v = R[kc - c + 15] * LOG2E; }
        else { const int cc = (e - 384) >> 5, c = 57 + cc, kc = 32 + ((e - 384) & 31); if (kc >= 48 && cc < 7) v = R[kc - c + 15] * LOG2E; }
        tn[idx] = v;
    }
}

template <int MODE>
__device__ __forceinline__ void attn_core(const bf16_t* qptr, long qstride, const bf16_t* kptr, const bf16_t* vptr, long kstride, int t_lo, int t_hi,
                                          const ATT_LAS char* tab, ATT_LAS char* vbuf, ATT_LAS float* scr, int lane) {
    asm volatile("" : "+v"(lane));
    const int l31 = lane & 31, hi = lane >> 5;
    bf16x8 qf[2][4];
    { const unsigned qo = (unsigned)(l31 * (int)qstride + 8 * hi) * 2u;
#pragma unroll
      for (int qh = 0; qh < 2; ++qh)
#pragma unroll
        for (int s = 0; s < 4; ++s) qf[qh][s] = *(const bf16x8*)((const char*)qptr + (size_t)(32 * qh) * qstride * 2 + qo + 32 * s); }
    const unsigned ko = (unsigned)(l31 * (int)kstride + 8 * hi) * 2u;
    const unsigned vo = (unsigned)((lane >> 2) * (int)kstride + 8 * (lane & 3)) * 2u;
    int lo[2][2];
#pragma unroll
    for (int kh = 0; kh < 2; ++kh)
#pragma unroll
        for (int qh = 0; qh < 2; ++qh) {
            if (MODE == 0) lo[kh][qh] = 4 * (32 * (kh - qh) + 4 * hi - l31 + 63);
            else {
                int v = 4 * (32 * kh + 4 * hi - 32 * qh - l31 + 63);
                if (kh == 0 && qh == 0 && l31 < 8) v = 4 * (128 + l31 * 32 + 4 * hi);
                if (kh == 1 && qh == 1 && l31 >= 25) v = 4 * (384 + (l31 - 25) * 32 + 4 * hi);
                lo[kh][qh] = v;
            }
        }
    f32x16 o[2][2];
#pragma unroll
    for (int a = 0; a < 2; ++a)
#pragma unroll
        for (int b = 0; b < 2; ++b)
#pragma unroll
            for (int r = 0; r < 16; ++r) o[a][b][r] = 0.f;
    float mrow[2] = {NEGV, NEGV}, lrow[2] = {0.f, 0.f};
    const ATT_LAS char* vp0 = vbuf + ((lane >> 4) & 1) * 32 + (lane & 3) * 8 + (4 * hi + ((lane & 15) >> 2)) * 64;
    for (int t = t_lo; t < t_hi; ++t) {
        const bf16_t* kt = kptr + (long)t * 64 * kstride; const bf16_t* vt = vptr + (long)t * 64 * kstride;
        asm volatile("s_waitcnt lgkmcnt(0)" ::: "memory");
#pragma unroll
        for (int pc = 0; pc < 8; ++pc)
            __builtin_amdgcn_global_load_lds((const unsigned*)((const char*)vt + ((size_t)(16 * (pc & 3)) * kstride + 32 * (pc >> 2)) * 2 + vo), (ATT_LAS unsigned*)(vbuf + pc * 1024), 16, 0, 0);
        bf16x8 kf[2][4];
#pragma unroll
        for (int kh = 0; kh < 2; ++kh)
#pragma unroll
            for (int s = 0; s < 4; ++s) kf[kh][s] = *(const bf16x8*)((const char*)kt + (size_t)(32 * kh) * kstride * 2 + ko + 32 * s);
        const ATT_LAS char* tt = tab + (MODE == 0 ? 256 * t : TABN_SET * t);
#pragma unroll
        for (int qh = 0; qh < 2; ++qh) {
            f32x16 p[2];
#pragma unroll
            for (int kh = 0; kh < 2; ++kh) {
                const ATT_LAS char* ta = tt + lo[kh][qh];
#pragma unroll
                for (int r = 0; r < 16; ++r) p[kh][r] = *(const ATT_LAS float*)(ta + 4 * ((r & 3) + 8 * (r >> 2)));
#pragma unroll
                for (int s = 0; s < 4; ++s) p[kh] = __builtin_amdgcn_mfma_f32_32x32x16_bf16(kf[kh][s], qf[qh][s], p[kh], 0, 0, 0);
            }
            float rm = __builtin_fmaxf(p[0][0], p[1][0]);
#pragma unroll
            for (int r = 1; r < 16; ++r) rm = __builtin_fmaxf(rm, __builtin_fmaxf(p[0][r], p[1][r]));
            { auto rr = __builtin_amdgcn_permlane32_swap(__float_as_uint(rm), __float_as_uint(rm), false, false); rm = __builtin_fmaxf(__uint_as_float(rr[0]), __uint_as_float(rr[1])); }
            const float mn = __builtin_fmaxf(mrow[qh], rm), alpha = __builtin_amdgcn_exp2f(mrow[qh] - mn);
            mrow[qh] = mn;
            float ps = 0.f;
#pragma unroll
            for (int kh = 0; kh < 2; ++kh)
#pragma unroll
                for (int r = 0; r < 16; ++r) { p[kh][r] = __builtin_amdgcn_exp2f(p[kh][r] - mn); ps += p[kh][r]; }
            lrow[qh] = lrow[qh] * alpha + ps;
            if (hi == 0) scr[l31] = alpha;
#pragma unroll
            for (int g = 0; g < 4; ++g) { const f32x4 a4 = *(const ATT_LAS f32x4*)(scr + 8 * g + 4 * hi);
#pragma unroll
                for (int i = 0; i < 4; ++i) { o[qh][0][4 * g + i] *= a4[i]; o[qh][1][4 * g + i] *= a4[i]; } }
            u32x4 pw[4];
#pragma unroll
            for (int ks = 0; ks < 4; ++ks)
#pragma unroll
                for (int i = 0; i < 4; ++i) pw[ks][i] = cvtpk(p[ks >> 1][8 * (ks & 1) + 2 * i], p[ks >> 1][8 * (ks & 1) + 2 * i + 1]);
            if (qh == 0) asm volatile("s_waitcnt vmcnt(0)" ::: "memory");
#pragma unroll
            for (int d0 = 0; d0 < 2; ++d0)
#pragma unroll
                for (int ks = 0; ks < 4; ++ks) {
                    const s16x4 vl = vtr(vp0 + d0 * 4096 + ks * 1024), vh = vtr(vp0 + d0 * 4096 + ks * 1024 + 512);
                    const bf16x8 vf = (bf16x8){vl[0], vl[1], vl[2], vl[3], vh[0], vh[1], vh[2], vh[3]};
                    o[qh][d0] = __builtin_amdgcn_mfma_f32_32x32x16_bf16(__builtin_bit_cast(bf16x8, pw[ks]), vf, o[qh][d0], 0, 0, 0);
                }
        }
    }
    asm volatile("s_waitcnt lgkmcnt(0)" ::: "memory");
    ATT_LAS bf16_t* stg = (ATT_LAS bf16_t*)vbuf;
#pragma unroll
    for (int qh = 0; qh < 2; ++qh) {
        float ls = lrow[qh];
        { auto rr = __builtin_amdgcn_permlane32_swap(__float_as_uint(ls), __float_as_uint(ls), false, false); ls = __uint_as_float(rr[0]) + __uint_as_float(rr[1]); }
        const float inv = __builtin_amdgcn_rcpf(ls);
        if (hi == 0) { scr[l31] = inv; scr[32 + 32 * qh + l31] = mrow[qh] + __builtin_amdgcn_logf(ls); }
#pragma unroll
        for (int g = 0; g < 4; ++g) { const f32x4 a4 = *(const ATT_LAS f32x4*)(scr + 8 * g + 4 * hi);
#pragma unroll
            for (int i = 0; i < 4; ++i) {
                const int r = 4 * g + i, row = 32 * qh + crow(r, hi);
                stg[row * 64 + l31] = (bf16_t)(cvtpk(o[qh][0][r] * a4[i], 0.f) & 0xffffu);
                stg[row * 64 + 32 + l31] = (bf16_t)(cvtpk(o[qh][1][r] * a4[i], 0.f) & 0xffffu);
            } }
    }
    asm volatile("s_waitcnt lgkmcnt(0)" ::: "memory");
}

struct Tensors {
    const bf16_t *QA, *KA, *VA, *GA, *QB, *KB, *VB, *GB;
    bf16_t *O16, *O4;
    float *L16, *L4;
    bf16_t* Y;
    const float *t5, *rpb;
};

__device__ __forceinline__ void epi_partial(const ATT_LAS char* vbuf, const ATT_LAS float* scr, bf16_t* Oc, float* Lc, long tok0, int tstride, int h, int lane) {
#pragma unroll
    for (int it = 0; it < 8; ++it) { const int row = it * 8 + (lane >> 3), ch = lane & 7;
        const u32x4 v = *(const ATT_LAS u32x4*)(vbuf + row * 128 + ch * 16);
        *(u32x4*)(Oc + (tok0 + (long)row * tstride) * PITCH + h * HD + ch * 8) = v; }
    Lc[(tok0 + (long)lane * tstride) * NH + h] = scr[32 + lane];
}
__device__ __forceinline__ void epi_merge(const ATT_LAS char* vbuf, const ATT_LAS float* scr, const Tensors& T, long tok0, int h, int lane) {
#pragma unroll
    for (int it = 0; it < 8; ++it) { const int row = it * 8 + (lane >> 3), ch = lane & 7; const long tok = tok0 + row;
        const u32x4 v1 = *(const ATT_LAS u32x4*)(vbuf + row * 128 + ch * 16);
        const size_t off = (size_t)tok * PITCH + h * HD + ch * 8;
        const u32x4 v4 = __builtin_nontemporal_load((const u32x4*)(T.O4 + off)), v16 = __builtin_nontemporal_load((const u32x4*)(T.O16 + off));
        const u32x4 gv = *(const u32x4*)(T.GA + off);
        const float L1 = scr[32 + row], L4 = __builtin_nontemporal_load(T.L4 + (size_t)tok * NH + h), L16 = __builtin_nontemporal_load(T.L16 + (size_t)tok * NH + h);
        const float Lm = __builtin_fmaxf(L1, __builtin_fmaxf(L4, L16));
        float w1 = __builtin_amdgcn_exp2f(L1 - Lm), w4 = __builtin_amdgcn_exp2f(L4 - Lm), w16 = __builtin_amdgcn_exp2f(L16 - Lm);
        const float inv = __builtin_amdgcn_rcpf(w1 + w4 + w16); w1 *= inv; w4 *= inv; w16 *= inv;
        u32x4 yo;
#pragma unroll
        for (int i = 0; i < 4; ++i) {
            const float a = (w1 * bflo(v1[i]) + w4 * bflo(v4[i]) + w16 * bflo(v16[i])) * silu(bflo(gv[i]));
            const float b = (w1 * bfhi(v1[i]) + w4 * bfhi(v4[i]) + w16 * bfhi(v16[i])) * silu(bfhi(gv[i]));
            yo[i] = cvtpk(a, b); }
        *(u32x4*)(T.Y + (size_t)tok * 2048 + h * HD + ch * 8) = yo; }
}
__device__ __forceinline__ void epi_gate(const ATT_LAS char* vbuf, const Tensors& T, long tok0, int h, int lane) {
#pragma unroll
    for (int it = 0; it < 8; ++it) { const int row = it * 8 + (lane >> 3), ch = lane & 7; const long tok = tok0 + row;
        const u32x4 v1 = *(const ATT_LAS u32x4*)(vbuf + row * 128 + ch * 16);
        const u32x4 gv = *(const u32x4*)(T.GB + (size_t)tok * PITCH + h * HD + ch * 8);
        u32x4 yo;
#pragma unroll
        for (int i = 0; i < 4; ++i) yo[i] = cvtpk(bflo(v1[i]) * silu(bflo(gv[i])), bfhi(v1[i]) * silu(bfhi(gv[i])));
        *(u32x4*)(T.Y + (size_t)tok * 2048 + 1024 + h * HD + ch * 8) = yo; }
}

__device__ __forceinline__ void attn_phase(ATT_LAS char* lds, const Tensors& T, int vcu, int tid) {
    const int lane = tid & 63, wave = __builtin_amdgcn_readfirstlane(tid >> 6);
    const int bh = vcu >> 1, half = vcu & 1, b = bh >> 4, h = bh & 15;
    build_tables(lds, T.t5, T.rpb, h, h, tid);
    __syncthreads();
    ATT_LAS char* vbuf = lds + wave * WAVE_STRIDE; ATT_LAS float* scr = (ATT_LAS float*)(vbuf + 8192);
    const long tb = (long)b * SEQ;
    for (int j = 0; j < 4; ++j) {
        const int u = wave + 8 * j;
        int dil, r, n, nb, br; bf16_t* Oc; float* Lc;
        if (u < 16) { dil = 16; br = 2; r = u; n = half; nb = 2; Oc = T.O16; Lc = T.L16; }
        else { dil = 4; br = 1; r = (u - 16) & 3; n = 4 * half + ((u - 16) >> 2); nb = 8; Oc = T.O4; Lc = T.L4; }
        const long tok0 = tb + r + (long)dil * 64 * n, ktok0 = tb + r + (long)dil * 64 * (n - 1);
        const int t_lo = n == 0 ? 1 : 0, t_hi = n == nb - 1 ? 2 : 3;
        attn_core<0>(T.QA + tok0 * PITCH + h * HD, (long)dil * PITCH, T.KA + ktok0 * PITCH + h * HD, T.VA + ktok0 * PITCH + h * HD, (long)dil * PITCH, t_lo, t_hi,
                     lds + TABD_OFF + br * 1024, vbuf, scr, lane);
        epi_partial(vbuf, scr, Oc, Lc, tok0, dil, h, lane);
    }
    for (int j = 0; j < 2; ++j) {
        const int i = 16 * half + wave + 8 * j, rs = i < 4 ? 0 : (i > 28 ? 24 : i - 4);
        const long tok0 = tb + 64 * i, ktok0 = tb + 64 * rs;
        attn_core<1>(T.QB + tok0 * PITCH + h * HD, (long)PITCH, T.KB + ktok0 * PITCH + h * HD, T.VB + ktok0 * PITCH + h * HD, (long)PITCH, 0, 8,
                     lds + TABN_OFF + (rs - i + 7) * TABN_SET, vbuf, scr, lane);
        epi_gate(vbuf, T, tok0, h, lane);
    }
    asm volatile("s_waitcnt vmcnt(0)" ::: "memory");
    __syncthreads();
    for (int j = 0; j < 2; ++j) {
        const int n = 16 * half + wave + 8 * j;
        const long tok0 = tb + 64 * n, ktok0 = tok0 - 64;
        const int t_lo = n == 0 ? 1 : 0, t_hi = n == 31 ? 2 : 3;
        attn_core<0>(T.QA + tok0 * PITCH + h * HD, (long)PITCH, T.KA + ktok0 * PITCH + h * HD, T.VA + ktok0 * PITCH + h * HD, (long)PITCH, t_lo, t_hi,
                     lds + TABD_OFF, vbuf, scr, lane);
        epi_merge(vbuf, scr, T, tok0, h, lane);
    }
}
}
#define GAS __attribute__((address_space(1)))
#define LAS __attribute__((address_space(3)))
typedef unsigned short bf16;
typedef unsigned v4u __attribute__((ext_vector_type(4)));
typedef float f32x4 __attribute__((ext_vector_type(4)));
constexpr int NWAVES = 8, NTHREADS = 512;
constexpr int BATCH = 8, SEQ = 2048, DM = 2048, M = BATCH * SEQ, NIN = 8192, MIX = 2048;
constexpr float LN_EPS = 1e-5f, ALPHA = 1.189207115002721f;
constexpr float C2 = 0.125f * 1.4426950408889634f;

constexpr size_t MiB = 1u << 20;
constexpr size_t WS_CTL = 0, CTL_BYTES = 1 * MiB;
constexpr size_t WS_XB = 1 * MiB;
constexpr size_t WS_Y = WS_XB;
constexpr size_t WS_WIN = 65 * MiB;
constexpr size_t WS_WOUT = 97 * MiB;
constexpr size_t WS_H = 105 * MiB;
constexpr size_t H_STRIDE = 32 * MiB;
constexpr size_t WS_O16 = WS_H + 8 * H_STRIDE, WS_O4 = WS_O16 + 32 * MiB;
constexpr size_t WS_L16 = WS_O4 + 32 * MiB, WS_L4 = WS_L16 + 1 * MiB;
constexpr size_t WS_END = WS_L4 + 1 * MiB;
constexpr int LDS_BYTES = 147456;
constexpr int RING_BYTES = 131072;
static_assert(att::LDS_END <= RING_BYTES, "attention LDS map");

__device__ __forceinline__ unsigned f2bf(float f) { unsigned u = __builtin_bit_cast(unsigned, f); return (u + 0x7fffu + ((u >> 16) & 1u)) >> 16; }
__device__ __forceinline__ unsigned pk2(float lo, float hi) { return f2bf(lo) | (f2bf(hi) << 16); }
__device__ __forceinline__ float wave_sum(float v) {
#pragma unroll
    for (int o = 1; o < 64; o <<= 1) v += __shfl_xor(v, o);
    return v;
}
__device__ __forceinline__ void p0_transpose_item(const float* W, int K, int N, bf16* WT, LAS float* scr, int item, int lane, float scale) {
    const int nblk = N / 32, kb = item / nblk, nb = item % nblk, k0 = 64 * kb, n0 = 32 * nb;
#pragma unroll 8
    for (int i = 0; i < 32; ++i) { const int kk = 2 * i + (lane >> 5); scr[kk * 33 + (lane & 31)] = W[(size_t)(k0 + kk) * N + n0 + (lane & 31)] * scale; }
    asm volatile("s_waitcnt lgkmcnt(0)" ::: "memory");
    const int c = lane & 7;
#pragma unroll
    for (int j = 0; j < 4; ++j) { const int n = (lane >> 3) + 8 * j; const LAS float* s = scr + (8 * c) * 33 + n;
        v4u o; o.x = pk2(s[0 * 33], s[1 * 33]); o.y = pk2(s[2 * 33], s[3 * 33]); o.z = pk2(s[4 * 33], s[5 * 33]); o.w = pk2(s[6 * 33], s[7 * 33]);
        *(v4u*)(WT + (size_t)(n0 + n) * K + k0 + 8 * c) = o; }
    asm volatile("s_waitcnt lgkmcnt(0)" ::: "memory");
}

struct Args { const float *x, *w_in, *w_out, *t5, *rpb, *gain, *bias; float* out; unsigned char* ws; int ph_lo, ph_hi; };

__global__ void __launch_bounds__(NTHREADS, 2) fwd_kernel(Args a) {
    extern __shared__ __attribute__((aligned(16))) unsigned char lds_raw[];
    LAS unsigned char* lds = (LAS unsigned char*)lds_raw;
    const int tid = threadIdx.x, lane = tid & 63, wave = __builtin_amdgcn_readfirstlane(tid >> 6);
    const int G = gridDim.x, bx = blockIdx.x, vcu = (G % 8 == 0) ? (bx % 8) * (G / 8) + bx / 8 : bx;
    unsigned char* ws = a.ws;
    bf16* XB = (bf16*)(ws + WS_XB); bf16* WIN = (bf16*)(ws + WS_WIN); bf16* WOUT = (bf16*)(ws + WS_WOUT); bf16* HB = (bf16*)(ws + WS_H); bf16* YB = (bf16*)(ws + WS_Y);
    const int gw = vcu * NWAVES + wave, NGW = G * NWAVES;
#define IN(k) (a.ph_lo <= (k) && (k) < a.ph_hi)
    if (IN(0)) {
        LAS float* scr = (LAS float*)(lds + wave * 16384);
        constexpr int I_IN = (DM / 64) * (NIN / 32), I_OUT = (MIX / 64) * (DM / 32);
        for (int it = gw; it < I_IN + I_OUT; it += NGW) {
            if (it < I_IN) { const int nb = it % (NIN / 32), n0 = 32 * nb; const bool isq = (n0 < 1024) || (n0 >= 4096 && n0 < 5120);
                p0_transpose_item(a.w_in, DM, NIN, WIN, scr, it, lane, isq ? C2 : 1.0f); }
            else p0_transpose_item(a.w_out, MIX, DM, WOUT, scr, it - I_IN, lane, 1.0f);
        }
        const size_t n8 = (size_t)M * DM / 8, gt = (size_t)bx * NTHREADS + tid, GT = (size_t)G * NTHREADS;
        for (size_t i = gt; i < n8; i += GT) { const f32x4 v0 = *(const f32x4*)(a.x + i * 8), v1 = *(const f32x4*)(a.x + i * 8 + 4);
            v4u o; o.x = pk2(v0.x, v0.y); o.y = pk2(v0.z, v0.w); o.z = pk2(v1.x, v1.y); o.w = pk2(v1.z, v1.w); *(v4u*)(XB + i * 8) = o; }
    }
    if (IN(1)) {
        pg8::Gemm g{XB, WIN, M, NIN, DM}; pg8::StaticOrder S; S.init(M, NIN, G, bx);
        pg8::EpiBf16<0> E{HB, 1024, nullptr, 1024, H_STRIDE / 2, 1.0f};
        pg8::gemm_phase<pg8::EpiBf16<0>, pg8::StaticOrder, true, true>(lds, g, S, E);
    }
    if (IN(2)) {
        __syncthreads();
        att::Tensors T;
        T.QA = HB; T.KA = HB + 1 * (H_STRIDE / 2); T.VA = HB + 2 * (H_STRIDE / 2); T.GA = HB + 3 * (H_STRIDE / 2);
        T.QB = HB + 4 * (H_STRIDE / 2); T.KB = HB + 5 * (H_STRIDE / 2); T.VB = HB + 6 * (H_STRIDE / 2); T.GB = HB + 7 * (H_STRIDE / 2);
        T.O16 = (bf16*)(ws + WS_O16); T.O4 = (bf16*)(ws + WS_O4); T.L16 = (float*)(ws + WS_L16); T.L4 = (float*)(ws + WS_L4);
        T.Y = YB; T.t5 = a.t5; T.rpb = a.rpb;
        att::attn_phase((ATT_LAS char*)lds, T, vcu, tid);
        __syncthreads();
    }
    if (IN(3)) {
        pg8::Gemm g{YB, WOUT, M, DM, MIX}; pg8::StaticOrder S; S.init(M, DM, G, bx);
        pg8::EpiResF32 E{a.out, DM, a.x, ALPHA};
        pg8::gemm_phase<pg8::EpiResF32, pg8::StaticOrder, true, true>(lds, g, S, E);
    }
    if (IN(4)) {
        f32x4 gv[8], bv[8];
#pragma unroll
        for (int j = 0; j < 8; ++j) { gv[j] = *(const f32x4*)(a.gain + 4 * lane + 256 * j); bv[j] = *(const f32x4*)(a.bias + 4 * lane + 256 * j); }
        for (int m = gw; m < M; m += NGW) {
            float* row = a.out + (size_t)m * DM; f32x4 v[8]; float s = 0.f;
#pragma unroll
            for (int j = 0; j < 8; ++j) { v[j] = *(const f32x4*)(row + 4 * lane + 256 * j); s += (v[j].x + v[j].y) + (v[j].z + v[j].w); }
            const float mean = wave_sum(s) * (1.f / DM); float s2 = 0.f;
#pragma unroll
            for (int j = 0; j < 8; ++j) { v[j] = v[j] - mean; s2 += (v[j].x * v[j].x + v[j].y * v[j].y) + (v[j].z * v[j].z + v[j].w * v[j].w); }
            const float rstd = 1.f / sqrtf(wave_sum(s2) * (1.f / DM) + LN_EPS);
#pragma unroll
            for (int j = 0; j < 8; ++j) *(f32x4*)(row + 4 * lane + 256 * j) = v[j] * rstd * gv[j] + bv[j];
        }
    }
#undef IN
}

extern "C" void kernel_launch(void* const* d_in, const int* in_sizes, int n_in, void* d_out, int out_size, void* d_ws, size_t ws_size, hipStream_t stream) {
    static int grid = 0;
    if (grid == 0) {
        if (n_in != 7 || in_sizes[0] != M * DM || out_size != M * DM || ws_size < WS_END) { fprintf(stderr, "kernel_launch: unexpected shapes (n_in %d, in0 %d, out %d, ws %zu)\n", n_in, n_in > 0 ? in_sizes[0] : -1, out_size, ws_size); grid = -1; return; }
        if (hipFuncSetAttribute((const void*)fwd_kernel, hipFuncAttributeMaxDynamicSharedMemorySize, LDS_BYTES) != hipSuccess) { fprintf(stderr, "kernel_launch: hipFuncSetAttribute failed\n"); grid = -1; return; }
        grid = 256;
    }
    if (grid < 0) return;
    Args a{};
    a.x = (const float*)d_in[0]; a.w_in = (const float*)d_in[1]; a.w_out = (const float*)d_in[2]; a.t5 = (const float*)d_in[3]; a.rpb = (const float*)d_in[4];
    a.gain = (const float*)d_in[5]; a.bias = (const float*)d_in[6]; a.out = (float*)d_out; a.ws = (unsigned char*)d_ws;
    for (int p = 0; p < 5; ++p) { a.ph_lo = p; a.ph_hi = p + 1; hipLaunchKernelGGL(fwd_kernel, dim3(grid), dim3(NTHREADS), LDS_BYTES, stream, a); }
}
```
